# Optimizing an MI355X kernel written in HIP

```python
import math
import jax, jax.numpy as jnp
from jax import lax
import numpy as np

D_MODEL = 1024
BATCH = 2
SEQ = 8192
DEPTH = 1

CHUNK = 64
Q_BLOCK = 128
ATT_WIDTH = D_MODEL // 2
ATT_HEAD_DIM = 64
ATT_HEADS = ATT_WIDTH // (2 * ATT_HEAD_DIM)
LRU_WIDTH = D_MODEL - ATT_WIDTH
LRU_BLOCKS = 8
LRU_BLOCK_DIM = LRU_WIDTH // LRU_BLOCKS
LRU_C = 8.0
CONV_WIDTH = 4
IN_COLS = 3 * ATT_WIDTH + 2 * LRU_WIDTH
N_EXPERTS = 32
TOP_K = 4
D_EXPERT = D_MODEL
SWIGLU_LIMIT = 7.0
SWIGLU_ALPHA = 1.702
EXPERT_BLOCK = 256
ALPHA = (2.0 * DEPTH) ** 0.25
BETA = (8.0 * DEPTH) ** -0.25
LN_EPS = 1e-5
SUBLN_EPS = 1e-5

kernel_name = "hybrid_diffattn_rglru_moe_deepnorm"


def layer_norm(x, g, b):
    xf = x.astype(jnp.float32)
    mu = jnp.mean(xf, axis=-1, keepdims=True)
    var = jnp.mean(jnp.square(xf - mu), axis=-1, keepdims=True)
    y = (xf - mu) * lax.rsqrt(var + LN_EPS) * g.astype(jnp.float32) + b.astype(jnp.float32)
    return y.astype(x.dtype)


def alibi_slopes(n):
    return jnp.asarray([2.0 ** (-8.0 * (i + 1) / n) for i in range(n)], dtype=jnp.float32)


def diff_attention(q, k, v, lam, subln_g, lam_init):
    B, S = q.shape[0], q.shape[1]
    nb = S // Q_BLOCK
    f32 = jnp.float32
    qf = (q.astype(f32) * (ATT_HEAD_DIM ** -0.5)).reshape(
        B, nb, Q_BLOCK, ATT_HEADS, 2, ATT_HEAD_DIM).transpose(1, 0, 3, 4, 2, 5)
    kf = k.astype(f32).transpose(0, 2, 3, 1, 4)
    vf = v.astype(f32).transpose(0, 2, 1, 3)
    slopes = alibi_slopes(ATT_HEADS)
    kpos = jnp.arange(S)

    def block(args):
        qb, bi = args
        qpos = bi * Q_BLOCK + jnp.arange(Q_BLOCK)
        s = jnp.einsum('bhmqd,bhmkd->bhmqk', qb, kf)
        dist = jnp.abs(qpos[:, None] - kpos[None, :]).astype(f32)
        bias = -slopes[:, None, None] * dist
        allowed = (kpos[None, :] // CHUNK) <= (qpos[:, None] // CHUNK)
        s = jnp.where(allowed, s + bias[None, :, None], -jnp.inf)
        p = jax.nn.softmax(s, axis=-1)
        a = p[:, :, 0] - lam * p[:, :, 1]
        return jnp.einsum('bhqk,bhkd->bhqd', a, vf)

    o = lax.map(block, (qf, jnp.arange(nb)))
    o = o.transpose(1, 0, 3, 2, 4).reshape(B, S, ATT_HEADS, 2 * ATT_HEAD_DIM)
    o = o * lax.rsqrt(jnp.mean(jnp.square(o), axis=-1, keepdims=True) + SUBLN_EPS)
    o = o * subln_g.astype(f32) * (1.0 - lam_init)
    return o.reshape(B, S, ATT_WIDTH)


def rg_lru_branch(xb, gb, conv_w, conv_b, w_a, b_a, w_x, b_x, lru_lambda):
    B, S = xb.shape[0], xb.shape[1]
    f32 = jnp.float32
    xc = lax.conv_general_dilated(
        xb, conv_w.astype(xb.dtype)[:, None, :], window_strides=(1,),
        padding=[(CONV_WIDTH - 1, 0)], dimension_numbers=('NWC', 'WIO', 'NWC'),
        feature_group_count=LRU_WIDTH)
    xc = xc.astype(f32) + conv_b.astype(f32)
    xh = xc.reshape(B, S, LRU_BLOCKS, LRU_BLOCK_DIM)
    r = jax.nn.sigmoid(jnp.einsum('bsnc,ncd->bsnd', xh, w_a.astype(f32)) + b_a.astype(f32)).reshape(B, S, LRU_WIDTH)
    i = jax.nn.sigmoid(jnp.einsum('bsnc,ncd->bsnd', xh, w_x.astype(f32)) + b_x.astype(f32)).reshape(B, S, LRU_WIDTH)
    log_a = -LRU_C * r * jax.nn.softplus(-lru_lambda.astype(f32))
    a = jnp.exp(log_a)
    u = jnp.sqrt(-jnp.expm1(2.0 * log_a)) * (i * xc)

    def combine(left, right):
        a1, b1 = left
        a2, b2 = right
        return a1 * a2, a2 * b1 + b2

    _, h = lax.associative_scan(combine, (a, u), axis=1)
    return (h * jax.nn.gelu(gb.astype(f32))).astype(xb.dtype)


def clamped_swiglu(h):
    x_glu = jnp.minimum(h[..., ::2], SWIGLU_LIMIT)
    x_lin = jnp.clip(h[..., 1::2], -SWIGLU_LIMIT, SWIGLU_LIMIT)
    return x_glu * jax.nn.sigmoid(SWIGLU_ALPHA * x_glu) * (x_lin + 1.0)


def moe(x, w_router, b_router, w_gu, b_gu, w_down, b_down):
    B, S, D = x.shape
    T = B * S
    A = T * TOP_K
    xt = x.reshape(T, D)
    logits = (xt @ w_router).astype(jnp.float32) + b_router.astype(jnp.float32)
    top_v, top_e = lax.top_k(logits, TOP_K)
    gates = jax.nn.softmax(top_v, axis=-1)
    flat_e = top_e.reshape(A)
    flat_tok = jnp.repeat(jnp.arange(T, dtype=jnp.int32), TOP_K)
    flat_g = gates.reshape(A)
    order = jnp.argsort(flat_e)
    sorted_e = flat_e[order]
    counts = jnp.bincount(flat_e, length=N_EXPERTS)
    starts = jnp.cumsum(counts) - counts
    padded = (counts + EXPERT_BLOCK - 1) // EXPERT_BLOCK * EXPERT_BLOCK
    pends = jnp.cumsum(padded)
    pstarts = pends - padded
    dest = pstarts[sorted_e] + (jnp.arange(A) - starts[sorted_e])
    num_blocks = (A + N_EXPERTS * (EXPERT_BLOCK - 1) + EXPERT_BLOCK - 1) // EXPERT_BLOCK
    R = num_blocks * EXPERT_BLOCK
    row_tok = jnp.zeros((R,), jnp.int32).at[dest].set(flat_tok[order])
    row_gate = jnp.zeros((R,), jnp.float32).at[dest].set(flat_g[order])
    block_e = jnp.minimum(
        jnp.searchsorted(pends, jnp.arange(num_blocks) * EXPERT_BLOCK, side='right'), N_EXPERTS - 1)

    def expert_block(args):
        tok, g, e = args
        xb = xt[tok]
        h = xb @ w_gu[e] + b_gu[e]
        y = clamped_swiglu(h) @ w_down[e] + b_down[e]
        return y * g[:, None].astype(y.dtype)

    ys = lax.map(expert_block, (row_tok.reshape(num_blocks, EXPERT_BLOCK),
                                row_gate.reshape(num_blocks, EXPERT_BLOCK), block_e))
    out = jax.ops.segment_sum(ys.reshape(R, D), row_tok, num_segments=T)
    return out.reshape(B, S, D).astype(x.dtype)


def setup_inputs(seed: int = 0) -> dict:
    key = jax.random.key(seed)
    ks = jax.random.split(key, 32)
    f32 = jnp.float32
    L = DEPTH
    nrm = lambda k, s, sc: jax.random.normal(k, s, f32) * sc
    x = jax.random.normal(ks[0], (BATCH, SEQ, D_MODEL), f32)
    ln0_g = 1.0 + nrm(ks[1], (D_MODEL,), 0.02)
    ln0_b = nrm(ks[2], (D_MODEL,), 0.02)
    w_in = nrm(ks[3], (L, D_MODEL, IN_COLS), D_MODEL ** -0.5)
    col_scale = jnp.ones((IN_COLS,), f32).at[2 * ATT_WIDTH:3 * ATT_WIDTH].set(BETA)
    w_in = w_in * col_scale
    conv_w = nrm(ks[4], (L, CONV_WIDTH, LRU_WIDTH), CONV_WIDTH ** -0.5)
    conv_b = nrm(ks[5], (L, LRU_WIDTH), 0.01)
    w_rg_a = nrm(ks[6], (L, LRU_BLOCKS, LRU_BLOCK_DIM, LRU_BLOCK_DIM), LRU_BLOCK_DIM ** -0.5)
    b_rg_a = nrm(ks[7], (L, LRU_BLOCKS, LRU_BLOCK_DIM), 0.01)
    w_rg_x = nrm(ks[8], (L, LRU_BLOCKS, LRU_BLOCK_DIM, LRU_BLOCK_DIM), LRU_BLOCK_DIM ** -0.5)
    b_rg_x = nrm(ks[9], (L, LRU_BLOCKS, LRU_BLOCK_DIM), 0.01)
    u = jax.random.uniform(ks[10], (L, LRU_WIDTH), f32, 0.9, 0.999)
    s = u ** (1.0 / LRU_C)
    lru_lambda = jnp.log(s) - jnp.log1p(-s)
    lam_q1 = nrm(ks[11], (L, ATT_HEAD_DIM), 0.1)
    lam_k1 = nrm(ks[12], (L, ATT_HEAD_DIM), 0.1)
    lam_q2 = nrm(ks[13], (L, ATT_HEAD_DIM), 0.1)
    lam_k2 = nrm(ks[14], (L, ATT_HEAD_DIM), 0.1)
    subln_g = 1.0 + nrm(ks[15], (L, 2 * ATT_HEAD_DIM), 0.02)
    w_out = nrm(ks[16], (L, D_MODEL, D_MODEL), BETA * D_MODEL ** -0.5)
    ln1_g = 1.0 + nrm(ks[17], (L, D_MODEL), 0.02)
    ln1_b = nrm(ks[18], (L, D_MODEL), 0.02)
    w_router = nrm(ks[19], (L, D_MODEL, N_EXPERTS), D_MODEL ** -0.5)
    b_router = nrm(ks[20], (L, N_EXPERTS), 0.01)
    w_gu = nrm(ks[21], (L, N_EXPERTS, D_MODEL, 2 * D_EXPERT), BETA * D_MODEL ** -0.5)
    b_gu = nrm(ks[22], (L, N_EXPERTS, 2 * D_EXPERT), 0.01)
    w_down = nrm(ks[23], (L, N_EXPERTS, D_EXPERT, D_MODEL), BETA * D_EXPERT ** -0.5)
    b_down = nrm(ks[24], (L, N_EXPERTS, D_MODEL), 0.01)
    ln2_g = 1.0 + nrm(ks[25], (L, D_MODEL), 0.02)
    ln2_b = nrm(ks[26], (L, D_MODEL), 0.02)
    return {"x": x, "ln0_g": ln0_g, "ln0_b": ln0_b, "w_in": w_in,
            "conv_w": conv_w, "conv_b": conv_b, "w_rg_a": w_rg_a, "b_rg_a": b_rg_a,
            "w_rg_x": w_rg_x, "b_rg_x": b_rg_x, "lru_lambda": lru_lambda,
            "lam_q1": lam_q1, "lam_k1": lam_k1, "lam_q2": lam_q2, "lam_k2": lam_k2,
            "subln_g": subln_g, "w_out": w_out, "ln1_g": ln1_g, "ln1_b": ln1_b,
            "w_router": w_router, "b_router": b_router, "w_gu": w_gu, "b_gu": b_gu,
            "w_down": w_down, "b_down": b_down, "ln2_g": ln2_g, "ln2_b": ln2_b}


def reference(x, ln0_g, ln0_b, w_in, conv_w, conv_b, w_rg_a, b_rg_a, w_rg_x, b_rg_x,
              lru_lambda, lam_q1, lam_k1, lam_q2, lam_k2, subln_g, w_out, ln1_g, ln1_b,
              w_router, b_router, w_gu, b_gu, w_down, b_down, ln2_g, ln2_b):
    B, S, _ = x.shape
    f32 = jnp.float32
    x = layer_norm(x, ln0_g, ln0_b)
    for l in range(DEPTH):
        lam_init = 0.8 - 0.6 * math.exp(-0.3 * l)
        proj = x @ w_in[l]
        q, k, v, xl, gl = jnp.split(
            proj, [ATT_WIDTH, 2 * ATT_WIDTH, 3 * ATT_WIDTH, 3 * ATT_WIDTH + LRU_WIDTH], axis=-1)
        q = q.reshape(B, S, ATT_HEADS, 2, ATT_HEAD_DIM)
        k = k.reshape(B, S, ATT_HEADS, 2, ATT_HEAD_DIM)
        v = v.reshape(B, S, ATT_HEADS, 2 * ATT_HEAD_DIM)
        lam = (jnp.exp(jnp.sum(lam_q1[l].astype(f32) * lam_k1[l].astype(f32)))
               - jnp.exp(jnp.sum(lam_q2[l].astype(f32) * lam_k2[l].astype(f32))) + lam_init)
        att = diff_attention(q, k, v, lam, subln_g[l], lam_init).astype(x.dtype)
        rec = rg_lru_branch(xl, gl, conv_w[l], conv_b[l], w_rg_a[l], b_rg_a[l],
                            w_rg_x[l], b_rg_x[l], lru_lambda[l])
        mixed = jnp.concatenate([att, rec], axis=-1) @ w_out[l]
        x = layer_norm(ALPHA * x + mixed, ln1_g[l], ln1_b[l])
        ffn = moe(x, w_router[l], b_router[l], w_gu[l], b_gu[l], w_down[l], b_down[l])
        x = layer_norm(ALPHA * x + ffn, ln2_g[l], ln2_b[l])
    return x
```

```cpp
#include <hip/hip_runtime.h>
#include <cstdint>
#include <cstdio>

constexpr int BATCH = 2, SEQ = 8192, DM = 1024, T = BATCH * SEQ;
constexpr int ATT_W = 512, NH = 4, HD = 64, LRU_W = 512, LRU_NB = 8, LRU_BD = 64;
constexpr int IN_COLS = 2560;
constexpr int C_Q = 0, C_K = 512, C_V = 1024, C_XL = 1536, C_GL = 2048;
constexpr int NE = 32, TOPK = 4, DE = 1024;
constexpr int MAX_TILES = 288;
constexpr int RMAX = MAX_TILES * 256;
constexpr float ALPHA = 1.189207115002721f;
constexpr float LN_EPS = 1e-5f, SUBLN_EPS = 1e-5f, LAM_INIT = 0.2f;

typedef unsigned short bf16;
__device__ __forceinline__ float bf2f(bf16 v) { return __uint_as_float(((unsigned)v) << 16); }
__device__ __forceinline__ bf16 f2bf(float f) { unsigned u = __float_as_uint(f); return (bf16)((u + 0x7fffu + ((u >> 16) & 1u)) >> 16); }

constexpr size_t MiB = 1u << 20;
constexpr size_t WS_CTL = 0;
constexpr size_t WS_X0 = 1 * MiB;
constexpr size_t WS_XN = 65 * MiB;
constexpr size_t WS_PROJ = 97 * MiB;
constexpr size_t WS_MIX = 177 * MiB;
constexpr size_t WS_X1 = 209 * MiB;
constexpr size_t WS_X1B = 273 * MiB;
constexpr size_t WS_ROUTE = 305 * MiB;
constexpr size_t WS_HS = 313 * MiB;
constexpr size_t WS_Y = 457 * MiB;
constexpr size_t WS_LA = 601 * MiB;
constexpr size_t WS_LU = 633 * MiB;
constexpr size_t WS_END = 665 * MiB;
constexpr size_t RT_TOPE = 0, RT_POS = 256 * 1024, RT_LIST = 512 * 1024, RT_LISTG = RT_LIST + 2 * MiB;
constexpr int CW_CNT = 64;
constexpr int CW_TOFF = 128;

__device__ __forceinline__ float wave_sum(float v) {
#pragma unroll
    for (int o = 1; o < 64; o <<= 1) v += __shfl_xor(v, o);
    return v;
}
__device__ __forceinline__ float wave_max(float v) {
#pragma unroll
    for (int o = 1; o < 64; o <<= 1) v = fmaxf(v, __shfl_xor(v, o));
    return v;
}

__global__ void __launch_bounds__(256) k_ln0(const float* __restrict__ x, const float* __restrict__ g, const float* __restrict__ b, float* X0, bf16* XN) {
    const int lane = threadIdx.x & 63, row = blockIdx.x * 4 + (threadIdx.x >> 6);
    const float* xr = x + (size_t)row * DM;
    float v[16]; float s = 0.f;
#pragma unroll
    for (int j = 0; j < 16; ++j) { v[j] = xr[lane + 64 * j]; s += v[j]; }
    const float mean = wave_sum(s) * (1.f / DM); float q = 0.f;
#pragma unroll
    for (int j = 0; j < 16; ++j) { v[j] -= mean; q += v[j] * v[j]; }
    const float rstd = 1.f / sqrtf(wave_sum(q) * (1.f / DM) + LN_EPS);
#pragma unroll
    for (int j = 0; j < 16; ++j) { const int c = lane + 64 * j; const float y = v[j] * rstd * g[c] + b[c]; X0[(size_t)row * DM + c] = y; XN[(size_t)row * DM + c] = f2bf(y); }
}

template <class ARow, class Epi>
__device__ __forceinline__ void gemm_tile64(const ARow& arow, const float* __restrict__ Bm, int ldb, int K, int tn, const Epi& epi) {
    __shared__ float As[16][65];
    __shared__ float Bs[16][64];
    const int tid = threadIdx.x, tx = tid & 15, ty = tid >> 4;
    float acc[4][4];
#pragma unroll
    for (int i = 0; i < 4; ++i)
#pragma unroll
        for (int j = 0; j < 4; ++j) acc[i][j] = 0.f;
    const int ar = tid >> 2, ak = (tid & 3) * 4;
    const bf16* ap = arow(ar);
    const int bk = tid >> 4, bc = (tid & 15) * 4;
    for (int k0 = 0; k0 < K; k0 += 16) {
        const uint2 av = *(const uint2*)(ap + k0 + ak);
        As[ak + 0][ar] = __uint_as_float(av.x << 16); As[ak + 1][ar] = __uint_as_float(av.x & 0xffff0000u);
        As[ak + 2][ar] = __uint_as_float(av.y << 16); As[ak + 3][ar] = __uint_as_float(av.y & 0xffff0000u);
        const float4 bv = *(const float4*)(Bm + (size_t)(k0 + bk) * ldb + tn + bc);
        Bs[bk][bc + 0] = bv.x; Bs[bk][bc + 1] = bv.y; Bs[bk][bc + 2] = bv.z; Bs[bk][bc + 3] = bv.w;
        __syncthreads();
#pragma unroll
        for (int kk = 0; kk < 16; ++kk) {
            float a[4], b[4];
#pragma unroll
            for (int i = 0; i < 4; ++i) a[i] = As[kk][ty * 4 + i];
#pragma unroll
            for (int j = 0; j < 4; ++j) b[j] = Bs[kk][tx * 4 + j];
#pragma unroll
            for (int i = 0; i < 4; ++i)
#pragma unroll
                for (int j = 0; j < 4; ++j) acc[i][j] += a[i] * b[j];
        }
        __syncthreads();
    }
#pragma unroll
    for (int i = 0; i < 4; ++i) epi(ty * 4 + i, tn + tx * 4, acc[i]);
}

__global__ void __launch_bounds__(256) k_inproj(const bf16* XN, const float* w_in, bf16* PROJ) {
    const int tm = blockIdx.y * 64, tn = blockIdx.x * 64;
    auto arow = [&](int r) { return XN + (size_t)(tm + r) * DM; };
    auto epi = [&](int r, int c, const float (&v)[4]) {
        bf16* o = PROJ + (size_t)(tm + r) * IN_COLS + c;
#pragma unroll
        for (int j = 0; j < 4; ++j) o[j] = f2bf(v[j]);
    };
    gemm_tile64(arow, w_in, IN_COLS, DM, tn, epi);
}

__global__ void __launch_bounds__(256) k_outproj(const bf16* MIX, const float* w_out, const float* X0, float* X1) {
    const int tm = blockIdx.y * 64, tn = blockIdx.x * 64;
    auto arow = [&](int r) { return MIX + (size_t)(tm + r) * DM; };
    auto epi = [&](int r, int c, const float (&v)[4]) {
        const size_t off = (size_t)(tm + r) * DM + c;
#pragma unroll
        for (int j = 0; j < 4; ++j) X1[off + j] = ALPHA * X0[off + j] + v[j];
    };
    gemm_tile64(arow, w_out, DM, DM, tn, epi);
}
__global__ void __launch_bounds__(256) k_ln1(float* X1, const float* __restrict__ g, const float* __restrict__ b, bf16* X1B) {
    const int lane = threadIdx.x & 63, row = blockIdx.x * 4 + (threadIdx.x >> 6);
    float* xr = X1 + (size_t)row * DM;
    float v[16]; float s = 0.f;
#pragma unroll
    for (int j = 0; j < 16; ++j) { v[j] = xr[lane + 64 * j]; s += v[j]; }
    const float mean = wave_sum(s) * (1.f / DM); float q = 0.f;
#pragma unroll
    for (int j = 0; j < 16; ++j) { v[j] -= mean; q += v[j] * v[j]; }
    const float rstd = 1.f / sqrtf(wave_sum(q) * (1.f / DM) + LN_EPS);
#pragma unroll
    for (int j = 0; j < 16; ++j) { const int c = lane + 64 * j; const float y = v[j] * rstd * g[c] + b[c]; xr[c] = y; X1B[(size_t)row * DM + c] = f2bf(y); }
}

__global__ void __launch_bounds__(256) k_attn_naive(const bf16* __restrict__ PROJ, const float* lq1, const float* lk1, const float* lq2, const float* lk2,
                                                    const float* __restrict__ subg, bf16* MIX) {
    const int lane = threadIdx.x & 63, gid = blockIdx.x * 4 + (threadIdx.x >> 6);
    const int t = gid >> 2, h = gid & 3, b = t / SEQ, pos = t % SEQ;
    const float lam = __expf(wave_sum(lq1[lane] * lk1[lane])) - __expf(wave_sum(lq2[lane] * lk2[lane])) + LAM_INIT;
    const float slope = exp2f(-2.f * (float)(h + 1));
    const bf16* qrow = PROJ + (size_t)t * IN_COLS + C_Q + h * 128;
    const float q0 = bf2f(qrow[lane]) * 0.125f, q1 = bf2f(qrow[64 + lane]) * 0.125f;
    float m0 = -INFINITY, m1 = -INFINITY, l0 = 0.f, l1 = 0.f, o0a = 0.f, o0b = 0.f, o1a = 0.f, o1b = 0.f;
    const int nblk = pos / 64 + 1;
    for (int kb = 0; kb < nblk; ++kb) {
        const int key = kb * 64 + lane;
        const bf16* krow = PROJ + (size_t)(b * SEQ + key) * IN_COLS + C_K + h * 128;
        float s0 = 0.f, s1 = 0.f;
#pragma unroll
        for (int c = 0; c < 8; ++c) {
            const uint4 k0 = *(const uint4*)(krow + c * 8), k1 = *(const uint4*)(krow + 64 + c * 8);
            const unsigned w0[4] = {k0.x, k0.y, k0.z, k0.w}, w1[4] = {k1.x, k1.y, k1.z, k1.w};
#pragma unroll
            for (int j = 0; j < 4; ++j) {
                const float qa = __shfl(q0, c * 8 + 2 * j), qb = __shfl(q0, c * 8 + 2 * j + 1);
                const float ra = __shfl(q1, c * 8 + 2 * j), rb = __shfl(q1, c * 8 + 2 * j + 1);
                s0 += qa * __uint_as_float(w0[j] << 16) + qb * __uint_as_float(w0[j] & 0xffff0000u);
                s1 += ra * __uint_as_float(w1[j] << 16) + rb * __uint_as_float(w1[j] & 0xffff0000u);
            }
        }
        const float bias = -slope * fabsf((float)(pos - key));
        s0 += bias; s1 += bias;
        const float n0 = fmaxf(m0, wave_max(s0)), n1 = fmaxf(m1, wave_max(s1));
        const float p0 = __expf(s0 - n0), p1 = __expf(s1 - n1), f0 = __expf(m0 - n0), f1 = __expf(m1 - n1);
        l0 = l0 * f0 + wave_sum(p0); l1 = l1 * f1 + wave_sum(p1);
        o0a *= f0; o0b *= f0; o1a *= f1; o1b *= f1; m0 = n0; m1 = n1;
        const bf16* vbase = PROJ + (size_t)(b * SEQ + kb * 64) * IN_COLS + C_V + h * 128 + lane * 2;
#pragma unroll 8
        for (int k = 0; k < 64; ++k) {
            const unsigned vv = *(const unsigned*)(vbase + (size_t)k * IN_COLS);
            const float va = __uint_as_float(vv << 16), vb = __uint_as_float(vv & 0xffff0000u);
            const float pa = __shfl(p0, k), pb = __shfl(p1, k);
            o0a += pa * va; o0b += pa * vb; o1a += pb * va; o1b += pb * vb;
        }
    }
    const float ra = o0a / l0 - lam * (o1a / l1), rb = o0b / l0 - lam * (o1b / l1);
    const float ms = wave_sum(ra * ra + rb * rb) * (1.f / 128.f);
    const float r = 1.f / sqrtf(ms + SUBLN_EPS) * (1.f - LAM_INIT);
    bf16* o = MIX + (size_t)t * DM + h * 128 + lane * 2;
    o[0] = f2bf(ra * r * subg[lane * 2]); o[1] = f2bf(rb * r * subg[lane * 2 + 1]);
}

__global__ void __launch_bounds__(64) k_lru_gates(const bf16* __restrict__ PROJ, const float* __restrict__ conv_w, const float* __restrict__ conv_b,
                                                  const float* __restrict__ w_a, const float* __restrict__ b_a, const float* __restrict__ w_x, const float* __restrict__ b_x,
                                                  const float* __restrict__ lam, float* LA, float* LU) {
    __shared__ float xs[64];
    const int t = blockIdx.x >> 3, n = blockIdx.x & 7, d = threadIdx.x, c = n * 64 + d, pos = t % SEQ;
    float xc = conv_b[c];
#pragma unroll
    for (int j = 0; j < 4; ++j) { const int pp = pos - 3 + j; if (pp >= 0) xc += conv_w[j * LRU_W + c] * bf2f(PROJ[(size_t)(t - 3 + j) * IN_COLS + C_XL + c]); }
    xs[d] = xc; __syncthreads();
    float ra = b_a[c], ri = b_x[c];
    for (int k = 0; k < 64; ++k) { const float xv = xs[k]; ra += xv * w_a[(size_t)(n * 64 + k) * 64 + d]; ri += xv * w_x[(size_t)(n * 64 + k) * 64 + d]; }
    const float r = 1.f / (1.f + expf(-ra)), ig = 1.f / (1.f + expf(-ri));
    const float L = lam[c]; const float sp = (L > 0.f) ? log1pf(expf(-L)) : (-L + log1pf(expf(L)));
    const float log_a = -8.f * r * sp;
    LA[(size_t)t * LRU_W + c] = expf(log_a);
    LU[(size_t)t * LRU_W + c] = sqrtf(-expm1f(2.f * log_a)) * (ig * xc);
}
__global__ void __launch_bounds__(64) k_lru_scan(const float* __restrict__ LA, const float* __restrict__ LU, const bf16* __restrict__ PROJ, bf16* MIX) {
    const int gid = blockIdx.x * 64 + threadIdx.x, b = gid / LRU_W, c = gid % LRU_W;
    float h = 0.f;
    for (int p = 0; p < SEQ; ++p) {
        const size_t t = (size_t)b * SEQ + p;
        h = LA[t * LRU_W + c] * h + LU[t * LRU_W + c];
        const float g = bf2f(PROJ[t * IN_COLS + C_GL + c]);
        const float ge = 0.5f * g * (1.f + tanhf(0.7978845608028654f * (g + 0.044715f * g * g * g)));
        MIX[t * DM + ATT_W + c] = f2bf(h * ge);
    }
}

__global__ void __launch_bounds__(256) k_router(const float* __restrict__ X1, const float* __restrict__ w_r, const float* __restrict__ b_r,
                                                unsigned* CTL, int* TOPE, int* POS, int* LIST, float* LISTG) {
    const int lane = threadIdx.x & 63, t = blockIdx.x * 4 + (threadIdx.x >> 6), e = lane & 31, half = lane >> 5;
    const float* xr = X1 + (size_t)t * DM + half * 512;
    const float* wr = w_r + (size_t)half * 512 * NE + e;
    float s = 0.f;
    for (int k = 0; k < 512; ++k) s += xr[k] * wr[(size_t)k * NE];
    s += __shfl_xor(s, 32);
    float logit = s + b_r[e];
    float tv[4]; int te[4];
#pragma unroll
    for (int k = 0; k < 4; ++k) {
        float bv = logit; int bi = e;
#pragma unroll
        for (int o = 1; o < 32; o <<= 1) { const float ov = __shfl_xor(bv, o); const int oi = __shfl_xor(bi, o); if (ov > bv || (ov == bv && oi < bi)) { bv = ov; bi = oi; } }
        tv[k] = bv; te[k] = bi;
        if (e == bi) logit = -INFINITY;
    }
    const float mx = tv[0]; float ex[4], den = 0.f;
#pragma unroll
    for (int k = 0; k < 4; ++k) { ex[k] = expf(tv[k] - mx); den += ex[k]; }
    if (lane == 0) {
#pragma unroll
        for (int k = 0; k < 4; ++k) {
            const int ee = te[k]; const int pos = (int)atomicAdd(&CTL[CW_CNT + ee], 1u);
            TOPE[t * 4 + k] = ee; POS[t * 4 + k] = pos; LIST[(size_t)ee * T + pos] = t; LISTG[(size_t)ee * T + pos] = ex[k] / den;
        }
    }
}
__global__ void k_offsets(unsigned* CTL) {
    if (threadIdx.x == 0) { unsigned off = 0; for (int e = 0; e < NE; ++e) { CTL[CW_TOFF + e] = off; off += (CTL[CW_CNT + e] + 255u) / 256u; } CTL[CW_TOFF + NE] = off; }
}

__device__ __forceinline__ int find_expert(const unsigned* CTL, int tile256) { int e = 0; for (int i = 1; i < NE; ++i) if ((int)CTL[CW_TOFF + i] <= tile256) e = i; return e; }
__global__ void __launch_bounds__(256) k_moe_gu(const bf16* X1B, const float* w_gu, const float* b_gu, const unsigned* CTL, const int* LIST, bf16* HS) {
    const int rt = blockIdx.y, tile256 = rt >> 2; if (tile256 >= (int)CTL[CW_TOFF + NE]) return;
    const int e = find_expert(CTL, tile256), cnt = (int)CTL[CW_CNT + e], j0 = (tile256 - (int)CTL[CW_TOFF + e]) * 256 + (rt & 3) * 64;
    const int tn = blockIdx.x * 64;
    auto arow = [&](int r) { const int j = j0 + r; const int tok = LIST[(size_t)e * T + (j < cnt ? j : 0)]; return X1B + (size_t)tok * DM; };
    const float* bias = b_gu + (size_t)e * 2 * DE;
    auto epi = [&](int r, int c, const float (&v)[4]) {
        bf16* o = HS + (size_t)(rt * 64 + r) * DE + (c >> 1);
#pragma unroll
        for (int p = 0; p < 2; ++p) {
            const float glu = fminf(v[2 * p] + bias[c + 2 * p], 7.f), lin = fminf(fmaxf(v[2 * p + 1] + bias[c + 2 * p + 1], -7.f), 7.f);
            o[p] = f2bf(glu / (1.f + expf(-1.702f * glu)) * (lin + 1.f));
        }
    };
    gemm_tile64(arow, w_gu + (size_t)e * DM * 2 * DE, 2 * DE, DM, tn, epi);
}
__global__ void __launch_bounds__(256) k_moe_down(const bf16* HS, const float* w_dn, const float* b_dn, const unsigned* CTL, const float* LISTG, bf16* Y) {
    const int rt = blockIdx.y, tile256 = rt >> 2; if (tile256 >= (int)CTL[CW_TOFF + NE]) return;
    const int e = find_expert(CTL, tile256), cnt = (int)CTL[CW_CNT + e], j0 = (tile256 - (int)CTL[CW_TOFF + e]) * 256 + (rt & 3) * 64;
    const int tn = blockIdx.x * 64;
    auto arow = [&](int r) { return HS + (size_t)(rt * 64 + r) * DE; };
    const float* bias = b_dn + (size_t)e * DM;
    auto epi = [&](int r, int c, const float (&v)[4]) {
        const int j = j0 + r; const float g = (j < cnt) ? LISTG[(size_t)e * T + j] : 0.f;
        bf16* o = Y + (size_t)(rt * 64 + r) * DM + c;
#pragma unroll
        for (int q = 0; q < 4; ++q) o[q] = f2bf((v[q] + bias[c + q]) * g);
    };
    gemm_tile64(arow, w_dn + (size_t)e * DE * DM, DM, DE, tn, epi);
}

__global__ void __launch_bounds__(256) k_final(const float* __restrict__ X1, const bf16* __restrict__ Y, const unsigned* CTL, const int* TOPE, const int* POS,
                                               const float* __restrict__ g, const float* __restrict__ b, float* out) {
    const int lane = threadIdx.x & 63, t = blockIdx.x * 4 + (threadIdx.x >> 6);
    const float* xr = X1 + (size_t)t * DM;
    const bf16* yr[4];
#pragma unroll
    for (int k = 0; k < 4; ++k) { const int e = TOPE[t * 4 + k]; yr[k] = Y + ((size_t)CTL[CW_TOFF + e] * 256 + POS[t * 4 + k]) * DM; }
    float v[16]; float s = 0.f;
#pragma unroll
    for (int j = 0; j < 16; ++j) { const int c = lane + 64 * j; float a = ALPHA * xr[c];
#pragma unroll
        for (int k = 0; k < 4; ++k) a += bf2f(yr[k][c]);
        v[j] = a; s += a; }
    const float mean = wave_sum(s) * (1.f / DM); float q = 0.f;
#pragma unroll
    for (int j = 0; j < 16; ++j) { v[j] -= mean; q += v[j] * v[j]; }
    const float rstd = 1.f / sqrtf(wave_sum(q) * (1.f / DM) + LN_EPS);
#pragma unroll
    for (int j = 0; j < 16; ++j) { const int c = lane + 64 * j; out[(size_t)t * DM + c] = v[j] * rstd * g[c] + b[c]; }
}

extern "C" void kernel_launch(void* const* d_in, const int* in_sizes, int n_in, void* d_out, int out_size, void* d_ws, size_t ws_size, hipStream_t stream) {
    if (n_in != 27 || ws_size < WS_END) { fprintf(stderr, "kernel_launch: unexpected n_in %d / ws %zu\n", n_in, ws_size); return; }
    const float* x = (const float*)d_in[0]; const float* ln0_g = (const float*)d_in[1]; const float* ln0_b = (const float*)d_in[2]; const float* w_in = (const float*)d_in[3];
    const float* conv_w = (const float*)d_in[4]; const float* conv_b = (const float*)d_in[5]; const float* w_rg_a = (const float*)d_in[6]; const float* b_rg_a = (const float*)d_in[7];
    const float* w_rg_x = (const float*)d_in[8]; const float* b_rg_x = (const float*)d_in[9]; const float* lru_lambda = (const float*)d_in[10];
    const float* lq1 = (const float*)d_in[11]; const float* lk1 = (const float*)d_in[12]; const float* lq2 = (const float*)d_in[13]; const float* lk2 = (const float*)d_in[14];
    const float* subln_g = (const float*)d_in[15]; const float* w_out = (const float*)d_in[16]; const float* ln1_g = (const float*)d_in[17]; const float* ln1_b = (const float*)d_in[18];
    const float* w_router = (const float*)d_in[19]; const float* b_router = (const float*)d_in[20]; const float* w_gu = (const float*)d_in[21]; const float* b_gu = (const float*)d_in[22];
    const float* w_down = (const float*)d_in[23]; const float* b_down = (const float*)d_in[24]; const float* ln2_g = (const float*)d_in[25]; const float* ln2_b = (const float*)d_in[26];
    unsigned char* ws = (unsigned char*)d_ws;
    unsigned* CTL = (unsigned*)(ws + WS_CTL);
    float* X0 = (float*)(ws + WS_X0); bf16* XN = (bf16*)(ws + WS_XN); bf16* PROJ = (bf16*)(ws + WS_PROJ); bf16* MIX = (bf16*)(ws + WS_MIX);
    float* X1 = (float*)(ws + WS_X1); bf16* X1B = (bf16*)(ws + WS_X1B); bf16* HS = (bf16*)(ws + WS_HS); bf16* Y = (bf16*)(ws + WS_Y);
    float* LA = (float*)(ws + WS_LA); float* LU = (float*)(ws + WS_LU);
    int* TOPE = (int*)(ws + WS_ROUTE + RT_TOPE); int* POS = (int*)(ws + WS_ROUTE + RT_POS); int* LIST = (int*)(ws + WS_ROUTE + RT_LIST); float* LISTG = (float*)(ws + WS_ROUTE + RT_LISTG);
    float* out = (float*)d_out;

    hipMemsetAsync(ws + WS_CTL, 0, 1 * MiB, stream);
    k_ln0<<<T / 4, 256, 0, stream>>>(x, ln0_g, ln0_b, X0, XN);
    k_inproj<<<dim3(IN_COLS / 64, T / 64), 256, 0, stream>>>(XN, w_in, PROJ);
    k_attn_naive<<<T * NH / 4, 256, 0, stream>>>(PROJ, lq1, lk1, lq2, lk2, subln_g, MIX);
    k_lru_gates<<<T * LRU_NB, 64, 0, stream>>>(PROJ, conv_w, conv_b, w_rg_a, b_rg_a, w_rg_x, b_rg_x, lru_lambda, LA, LU);
    k_lru_scan<<<BATCH * LRU_W / 64, 64, 0, stream>>>(LA, LU, PROJ, MIX);
    k_outproj<<<dim3(DM / 64, T / 64), 256, 0, stream>>>(MIX, w_out, X0, X1);
    k_ln1<<<T / 4, 256, 0, stream>>>(X1, ln1_g, ln1_b, X1B);
    k_router<<<T / 4, 256, 0, stream>>>(X1, w_router, b_router, CTL, TOPE, POS, LIST, LISTG);
    k_offsets<<<1, 64, 0, stream>>>(CTL);
    k_moe_gu<<<dim3(2 * DE / 64, MAX_TILES * 4), 256, 0, stream>>>(X1B, w_gu, b_gu, CTL, LIST, HS);
    k_moe_down<<<dim3(DM / 64, MAX_TILES * 4), 256, 0, stream>>>(HS, w_down, b_down, CTL, LISTG, Y);
    k_final<<<T / 4, 256, 0, stream>>>(X1, Y, CTL, TOPE, POS, ln2_g, ln2_b, out);
}
```
